# Optimizing an MI355X kernel written in HIP

```python
import jax, jax.numpy as jnp
from jax import lax
import numpy as np

D_MODEL = 1024
BATCH = 8
SEQ = 2048
DEPTH = 2

GRID_W = 64
CTX_LEN = 256
HEAD_DIM = 64
D_MIX = D_MODEL
LRU_WIDTH = D_MIX // 2
LRU_HEADS = LRU_WIDTH // HEAD_DIM
SC_WIDTH = D_MIX // 4
SC_GROUPS = SC_WIDTH // HEAD_DIM
CM_WIDTH = D_MIX // 4
CM_HEADS = CM_WIDTH // HEAD_DIM
CHUNK = 128
LRU_CONV = 4
LRU_CONV_LEFT = 2
SC_CONV = 3
SC_CONV_LEFT = 1
LRU_C = 8.0
D_FF = 2816
N_SUB = 3
EPS = 1e-6
D_IN = 2 * LRU_WIDTH + 3 * SC_WIDTH + 2 * CM_WIDTH
IN_OFFSETS = (LRU_WIDTH, 2 * LRU_WIDTH, 2 * LRU_WIDTH + SC_WIDTH, 2 * LRU_WIDTH + 2 * SC_WIDTH,
              2 * LRU_WIDTH + 3 * SC_WIDTH, 2 * LRU_WIDTH + 3 * SC_WIDTH + CM_WIDTH)

kernel_name = "hybrid_rglru_shortconv_chunkmlp_dit"


def rms_norm(x, g):
    xf = x.astype(jnp.float32)
    y = xf * lax.rsqrt(jnp.mean(xf * xf, axis=-1, keepdims=True) + EPS)
    return (y * g.astype(jnp.float32)).astype(x.dtype)


def sandwich(x, fn, mod3, g_pre, g_post, weight):
    shift, scale, gate = mod3
    h = rms_norm(x, g_pre) * (1 + scale) + shift
    return x + weight * gate * rms_norm(fn(h), g_post)


def swiglu(h, w_in, w_out):
    g, u = jnp.split(h @ w_in, 2, axis=-1)
    return (jax.nn.silu(g) * u) @ w_out


def dwconv(x, w, b, left):
    K = w.shape[0]
    L = x.shape[1]
    xp = jnp.pad(x, ((0, 0), (left, K - 1 - left), (0, 0)))
    y = b + w[0] * xp[:, 0:L]
    for k in range(1, K):
        y = y + w[k] * xp[:, k:k + L]
    return y


def seq_conv3(z, w, b):
    return dwconv(z, w, b, SC_CONV_LEFT)


def row_conv3(z, w, b):
    B, L, C = z.shape
    rows = L // GRID_W
    return dwconv(z.reshape(B * rows, GRID_W, C), w, b, SC_CONV_LEFT).reshape(B, L, C)


def linear_scan(a, b, h0):
    b = b.at[:, 0].add(a[:, 0] * h0)
    def combine(l, r):
        return (l[0] * r[0], r[0] * l[1] + r[1])
    return lax.associative_scan(combine, (a, b), axis=1)[1]


def lru_coeffs(xc, w_r, b_r, w_i, b_i, lam):
    B, L, _ = xc.shape
    xf = xc.astype(jnp.float32)
    xh = xf.reshape(B, L, LRU_HEADS, HEAD_DIM)
    r = jax.nn.sigmoid(jnp.einsum('blhi,hij->blhj', xh, w_r.astype(jnp.float32)).reshape(B, L, LRU_WIDTH) + b_r)
    i = jax.nn.sigmoid(jnp.einsum('blhi,hij->blhj', xh, w_i.astype(jnp.float32)).reshape(B, L, LRU_WIDTH) + b_i)
    log_a = -LRU_C * r * jax.nn.softplus(-lam.astype(jnp.float32))
    a = jnp.exp(log_a)
    bx = jnp.sqrt(-jnp.expm1(2.0 * log_a)) * (i * xf)
    return a, bx


def bidir_rglru(xc_ctx, xc_lat, w_r, b_r, w_i, b_i, lam, need_ctx_out):
    y_ctx = None
    y_lat = None
    h0 = jnp.zeros((xc_lat.shape[0], LRU_WIDTH), jnp.float32)
    for d in range(2):
        a_c, b_c = lru_coeffs(xc_ctx, w_r[d], b_r[d], w_i[d], b_i[d], lam[d])
        a_l, b_l = lru_coeffs(xc_lat, w_r[d], b_r[d], w_i[d], b_i[d], lam[d])
        if d == 1:
            a_c, b_c, a_l, b_l = (jnp.flip(t, axis=1) for t in (a_c, b_c, a_l, b_l))
        h_c = linear_scan(a_c, b_c, h0)
        h_l = linear_scan(a_l, b_l, h_c[:, -1])
        if d == 1:
            h_c, h_l = jnp.flip(h_c, axis=1), jnp.flip(h_l, axis=1)
        y_lat = h_l if y_lat is None else y_lat + h_l
        if need_ctx_out:
            y_ctx = h_c if y_ctx is None else y_ctx + h_c
    return y_ctx, y_lat


def chunk_mix(u, v, ws, bs):
    B, L, C = v.shape
    n = L // CHUNK
    vh = v.reshape(B, n, CHUNK, CM_HEADS, HEAD_DIM)
    s = jnp.einsum('hpq,bnqhd->bnphd', ws, vh) + bs.T[None, None, :, :, None]
    return u * s.reshape(B, L, C)


def head_groups(parts, y_lru, sc_w, sc_b, cm_w, cm_b, conv_fn):
    _, lru_gate, sc_bg, sc_cg, sc_x, cm_u, cm_v = parts
    o_lru = jax.nn.gelu(lru_gate) * y_lru.astype(lru_gate.dtype)
    o_sc = sc_bg * conv_fn(sc_cg * sc_x, sc_w, sc_b)
    o_cm = chunk_mix(jax.nn.gelu(cm_u), jax.nn.gelu(cm_v), cm_w, cm_b)
    return jnp.concatenate([o_lru, o_sc, o_cm], axis=-1)


def setup_inputs(seed: int = 0) -> dict:
    key = jax.random.key(seed)
    ks = jax.random.split(key, 24)
    f32 = jnp.float32

    def nrm(k, shape, scale):
        return jax.random.normal(k, shape, f32) * scale

    u = jax.random.uniform(ks[17], (DEPTH, 2, LRU_WIDTH), f32, minval=0.9, maxval=0.999)
    s = u ** (1.0 / LRU_C)
    return {
        "x": nrm(ks[0], (BATCH, SEQ, D_MODEL), 1.0),
        "c": nrm(ks[1], (BATCH, D_MODEL), 1.0),
        "ctx": nrm(ks[2], (BATCH, CTX_LEN, D_MODEL), 1.0),
        "c_ctx": nrm(ks[3], (D_MODEL,), 1.0),
        "w_mod": nrm(ks[4], (DEPTH, D_MODEL, 3 * N_SUB * D_MODEL), 0.5 * D_MODEL ** -0.5),
        "b_mod": nrm(ks[5], (DEPTH, 3 * N_SUB * D_MODEL), 0.01),
        "norm_pre": 1.0 + nrm(ks[6], (DEPTH, N_SUB, D_MODEL), 0.05),
        "norm_post": 1.0 + nrm(ks[7], (DEPTH, N_SUB, D_MODEL), 0.05),
        "ffn_w_in": nrm(ks[8], (DEPTH, 2, D_MODEL, 2 * D_FF), D_MODEL ** -0.5),
        "ffn_w_out": nrm(ks[9], (DEPTH, 2, D_FF, D_MODEL), D_FF ** -0.5),
        "w_mix_in": nrm(ks[10], (DEPTH, D_MODEL, D_IN), D_MODEL ** -0.5),
        "w_mix_out": nrm(ks[11], (DEPTH, D_MIX, D_MODEL), D_MIX ** -0.5),
        "lru_conv_w": nrm(ks[12], (DEPTH, LRU_CONV, LRU_WIDTH), LRU_CONV ** -0.5),
        "lru_conv_b": nrm(ks[13], (DEPTH, LRU_WIDTH), 0.01),
        "lru_w_r": nrm(ks[14], (DEPTH, 2, LRU_HEADS, HEAD_DIM, HEAD_DIM), HEAD_DIM ** -0.5),
        "lru_b_r": nrm(ks[15], (DEPTH, 2, LRU_WIDTH), 0.01),
        "lru_w_i": nrm(ks[16], (DEPTH, 2, LRU_HEADS, HEAD_DIM, HEAD_DIM), HEAD_DIM ** -0.5),
        "lru_b_i": nrm(ks[18], (DEPTH, 2, LRU_WIDTH), 0.01),
        "lru_lambda": jnp.log(s) - jnp.log1p(-s),
        "sc_conv_w": nrm(ks[19], (DEPTH, SC_CONV, SC_WIDTH), SC_CONV ** -0.5),
        "sc_conv_b": nrm(ks[20], (DEPTH, SC_WIDTH), 0.01),
        "cm_w_s": nrm(ks[21], (DEPTH, CM_HEADS, CHUNK, CHUNK), CHUNK ** -0.5),
        "cm_b_s": 1.0 + nrm(ks[22], (DEPTH, CM_HEADS, CHUNK), 0.05),
    }


def reference(x, c, ctx, c_ctx, w_mod, b_mod, norm_pre, norm_post, ffn_w_in, ffn_w_out,
              w_mix_in, w_mix_out, lru_conv_w, lru_conv_b, lru_w_r, lru_b_r, lru_w_i, lru_b_i,
              lru_lambda, sc_conv_w, sc_conv_b, cm_w_s, cm_b_s):
    xl, xc = x, ctx
    for l in range(DEPTH):
        last = l == DEPTH - 1
        mod_l = (jax.nn.silu(c) @ w_mod[l] + b_mod[l])[:, None, :]
        mod_c = (jax.nn.silu(c_ctx) @ w_mod[l] + b_mod[l])[None, None, :]
        ml = jnp.split(mod_l, 3 * N_SUB, axis=-1)
        mc = jnp.split(mod_c, 3 * N_SUB, axis=-1)

        ffn0 = lambda h, l=l: swiglu(h, ffn_w_in[l, 0], ffn_w_out[l, 0])
        xl = sandwich(xl, ffn0, ml[0:3], norm_pre[l, 0], norm_post[l, 0], 0.5)
        xc = sandwich(xc, ffn0, mc[0:3], norm_pre[l, 0], norm_post[l, 0], 0.5)

        hl = rms_norm(xl, norm_pre[l, 1]) * (1 + ml[4]) + ml[3]
        hc = rms_norm(xc, norm_pre[l, 1]) * (1 + mc[4]) + mc[3]
        pl = jnp.split(hl @ w_mix_in[l], IN_OFFSETS, axis=-1)
        xl_lru = dwconv(pl[0], lru_conv_w[l], lru_conv_b[l], LRU_CONV_LEFT)
        if last:
            pc = None
            xc_lru = dwconv(hc @ w_mix_in[l][:, :LRU_WIDTH], lru_conv_w[l], lru_conv_b[l], LRU_CONV_LEFT)
        else:
            pc = jnp.split(hc @ w_mix_in[l], IN_OFFSETS, axis=-1)
            xc_lru = dwconv(pc[0], lru_conv_w[l], lru_conv_b[l], LRU_CONV_LEFT)
        y_c, y_l = bidir_rglru(xc_lru, xl_lru, lru_w_r[l], lru_b_r[l], lru_w_i[l], lru_b_i[l],
                               lru_lambda[l], not last)
        mix_l = head_groups(pl, y_l, sc_conv_w[l], sc_conv_b[l], cm_w_s[l], cm_b_s[l], row_conv3) @ w_mix_out[l]
        xl = xl + ml[5] * rms_norm(mix_l, norm_post[l, 1])
        if not last:
            mix_c = head_groups(pc, y_c, sc_conv_w[l], sc_conv_b[l], cm_w_s[l], cm_b_s[l], seq_conv3) @ w_mix_out[l]
            xc = xc + mc[5] * rms_norm(mix_c, norm_post[l, 1])

        ffn1 = lambda h, l=l: swiglu(h, ffn_w_in[l, 1], ffn_w_out[l, 1])
        xl = sandwich(xl, ffn1, ml[6:9], norm_pre[l, 2], norm_post[l, 2], 0.5)
        if not last:
            xc = sandwich(xc, ffn1, mc[6:9], norm_pre[l, 2], norm_post[l, 2], 0.5)
    return xl
```

```cpp
#include <hip/hip_runtime.h>
#include <cstdio>
#include <cstdint>
#include <cmath>

typedef unsigned short bf16;

constexpr int D = 1024, NB = 8, SEQ = 2048, CTXL = 256, DEPTH = 2, DFF = 2816, DIN = 2304;
constexpr int ML = NB * SEQ;
constexpr int MC = NB * CTXL;
constexpr int MT = ML + MC;
constexpr int NP = 2048;
constexpr float EPS = 1e-6f;

constexpr size_t MiB = 1u << 20;
constexpr size_t WS_CTL = 0;
constexpr size_t WS_MOD = 1 * MiB;
constexpr size_t WS_GW = 2 * MiB;
constexpr size_t WS_CMW = 2 * MiB + 768 * 1024;
constexpr size_t WS_SP = 2 * MiB + 512 * 1024;
constexpr size_t WS_SUM = 3 * MiB;
constexpr size_t WS_XC = 6 * MiB;
constexpr size_t WS_WMO = 14 * MiB;
constexpr size_t WS_WMI = 18 * MiB;
constexpr size_t WS_W2 = 27 * MiB;
constexpr size_t WS_W1 = 49 * MiB;
constexpr size_t WS_HA = 93 * MiB;
constexpr size_t WS_MIX = 129 * MiB;
constexpr size_t WS_ACT = 165 * MiB;
constexpr size_t WS_P = 264 * MiB;
constexpr size_t WS_END = 352 * MiB;

__device__ __forceinline__ float bf2f(bf16 v) { return __uint_as_float(((unsigned)v) << 16); }
__device__ __forceinline__ bf16 f2bf(float f) { unsigned u = __float_as_uint(f); return (bf16)((u + 0x7fffu + ((u >> 16) & 1u)) >> 16); }
__device__ __forceinline__ float gelu_tanh(float x) { const float u = 0.7978845608028654f * (x + 0.044715f * x * x * x); return 0.5f * x * (1.f + tanhf(u)); }
__device__ __forceinline__ float silu(float x) { return x / (1.f + expf(-x)); }
__device__ __forceinline__ float sigmoidf(float x) { return 1.f / (1.f + expf(-x)); }

__device__ __forceinline__ int src_col(int mode, int vr) {
    if (mode == 0) return vr;
    if (mode == 1) { const int pn = vr >> 8, bj = (vr >> 7) & 1, r = vr & 127; return bj * DFF + 128 * pn + r; }
    const int pn = vr >> 8, r = vr & 255;
    if (pn < 4) return vr;
    if (pn == 4) return 1024 + r;
    if (pn == 5 || pn == 6) { const int bj = r >> 7, rr = r & 127; return (bj ? 1536 : 1280) + (pn - 5) * 128 + rr; }
    if (pn == 7) return 1792 + r;
    return 2048 + r;
}
__global__ void k_transpose(const float* __restrict__ in, bf16* __restrict__ out, int K, int Nsrc, int mode) {
    __shared__ float t[32][33];
    const int vr0 = blockIdx.x * 32, k0 = blockIdx.y * 32;
    for (int i = threadIdx.y; i < 32; i += 8) t[i][threadIdx.x] = in[(size_t)(k0 + i) * Nsrc + src_col(mode, vr0 + threadIdx.x)];
    __syncthreads();
    for (int i = threadIdx.y; i < 32; i += 8) out[(size_t)(vr0 + i) * K + k0 + threadIdx.x] = f2bf(t[threadIdx.x][i]);
}
__global__ void k_prep_small(const float* wr, const float* wi, const float* cmw, const float* lam, bf16* GW, bf16* CMW, float* SP) {
    const int idx = blockIdx.x * blockDim.x + threadIdx.x;
    if (idx < 2 * 2 * 2 * 8 * 64 * 64) {
        int i = idx & 63, j = (idx >> 6) & 63, h = (idx >> 12) & 7, g = (idx >> 15) & 1, d = (idx >> 16) & 1, l = idx >> 17;
        const float* src = g ? wi : wr;
        GW[idx] = f2bf(src[((((size_t)l * 2 + d) * 8 + h) * 64 + i) * 64 + j]);
    }
    if (idx < 2 * 4 * 128 * 128) CMW[idx] = f2bf(cmw[idx]);
    if (idx < 2 * 2 * 512) SP[idx] = 8.0f * log1pf(expf(-lam[idx]));
}
__global__ void k_mod(const float* c, const float* cctx, const float* wmod, const float* bmod, float* mod) {
    __shared__ float sc[9][1024];
    for (int i = threadIdx.x; i < 9 * 1024; i += blockDim.x) { const int r = i >> 10, k = i & 1023; const float v = r < 8 ? c[r * 1024 + k] : cctx[k]; sc[r][k] = silu(v); }
    __syncthreads();
    const int n = blockIdx.x * blockDim.x + threadIdx.x, l = blockIdx.y;
    float acc[9];
    for (int r = 0; r < 9; ++r) acc[r] = 0.f;
    const float* w = wmod + (size_t)l * 1024 * 9216 + n;
    for (int k = 0; k < 1024; ++k) { const float wv = w[(size_t)k * 9216];
        for (int r = 0; r < 9; ++r) acc[r] += sc[r][k] * wv; }
    for (int r = 0; r < 9; ++r) mod[((size_t)l * 9 + r) * 9216 + n] = acc[r] + bmod[l * 9216 + n];
}
__device__ __forceinline__ float wave_sum(float v) {
#pragma unroll
    for (int o = 1; o < 64; o <<= 1) v += __shfl_xor(v, o);
    return v;
}
__device__ __forceinline__ int mod_row(int row) { return row < ML ? row / SEQ : 8; }
__global__ void k_norm_mod(const float* xl, const float* xc, const float* g, const float* mod  , int sub, bf16* HA) {
    const int row = blockIdx.x * 4 + (threadIdx.x >> 6), lane = threadIdx.x & 63;
    const float* x = row < ML ? xl + (size_t)row * D : xc + (size_t)(row - ML) * D;
    const float* m = mod + (size_t)mod_row(row) * 9216 + sub * 3 * D;
    float v[16]; float s = 0.f;
    for (int j = 0; j < 16; ++j) { v[j] = x[lane + 64 * j]; s += v[j] * v[j]; }
    const float rs = rsqrtf(wave_sum(s) * (1.f / D) + EPS);
    for (int j = 0; j < 16; ++j) { const int cidx = lane + 64 * j; HA[(size_t)row * D + cidx] = f2bf(v[j] * rs * g[cidx] * (1.f + m[D + cidx]) + m[cidx]); }
}
__global__ void k_resid(const float* y, const float* basel, const float* basec, float* outl, float* outc, const float* gpost, const float* mod, int sub, float wgt,
                        const float* gpre_n, const float* mod_n, int sub_n, bf16* HA, int row_off) {
    const int row = row_off + blockIdx.x * 4 + (threadIdx.x >> 6), lane = threadIdx.x & 63;
    const float* b = row < ML ? basel + (size_t)row * D : basec + (size_t)(row - ML) * D;
    float* o = row < ML ? outl + (size_t)row * D : outc + (size_t)(row - ML) * D;
    const float* m = mod + (size_t)mod_row(row) * 9216 + sub * 3 * D;
    const float* yr = y + (size_t)row * D;
    float v[16]; float s = 0.f;
    for (int j = 0; j < 16; ++j) { v[j] = yr[lane + 64 * j]; s += v[j] * v[j]; }
    const float rs = rsqrtf(wave_sum(s) * (1.f / D) + EPS);
    float s2 = 0.f;
    for (int j = 0; j < 16; ++j) { const int cidx = lane + 64 * j; v[j] = b[cidx] + wgt * m[2 * D + cidx] * (v[j] * rs * gpost[cidx]); o[cidx] = v[j]; s2 += v[j] * v[j]; }
    if (HA) {
        const float rs2 = rsqrtf(wave_sum(s2) * (1.f / D) + EPS);
        const float* mn = mod_n + (size_t)mod_row(row) * 9216 + sub_n * 3 * D;
        for (int j = 0; j < 16; ++j) { const int cidx = lane + 64 * j; HA[(size_t)row * D + cidx] = f2bf(v[j] * rs2 * gpre_n[cidx] * (1.f + mn[D + cidx]) + mn[cidx]); }
    }
}

template <int MODE>
__global__ __launch_bounds__(256) void k_gemm(const bf16* __restrict__ A, const bf16* __restrict__ Bt, int K, void* __restrict__ outp, int row_off) {
    constexpr int BKK = 32;
    __shared__ float As[64][BKK + 1], Bs[64][BKK + 1], Cs[64][BKK + 1];
    const int tid = threadIdx.x, tx = tid & 15, ty = tid >> 4;
    const int row0 = row_off + blockIdx.y * 64, oc0 = blockIdx.x * 64;
    int b0 = oc0, b1 = -1, act = 0;
    if (MODE == 1) { b0 = 256 * (oc0 >> 7) + (oc0 & 127); b1 = b0 + 128; }
    if (MODE == 2) {
        if (oc0 < 1280) { b0 = oc0; act = (oc0 >= 512 && oc0 < 1024) ? 1 : 0; }
        else if (oc0 < 1536) { const int t = oc0 - 1280; b0 = 256 * (5 + (t >> 7)) + (t & 127); b1 = b0 + 128; }
        else { b0 = oc0 + 256; act = 1; }
    }
    float acc[4][4], acc2[4][4];
    for (int i = 0; i < 4; ++i) for (int j = 0; j < 4; ++j) { acc[i][j] = 0.f; acc2[i][j] = 0.f; }
    for (int k0 = 0; k0 < K; k0 += BKK) {
        for (int e = tid; e < 64 * BKK; e += 256) { const int r = e / BKK, kk = e % BKK;
            As[r][kk] = bf2f(A[(size_t)(row0 + r) * K + k0 + kk]);
            Bs[r][kk] = bf2f(Bt[(size_t)(b0 + r) * K + k0 + kk]);
            if (b1 >= 0) Cs[r][kk] = bf2f(Bt[(size_t)(b1 + r) * K + k0 + kk]); }
        __syncthreads();
        for (int kk = 0; kk < BKK; ++kk) {
            float a[4], b[4], c[4];
            for (int i = 0; i < 4; ++i) { a[i] = As[ty * 4 + i][kk]; b[i] = Bs[tx * 4 + i][kk]; c[i] = (b1 >= 0) ? Cs[tx * 4 + i][kk] : 0.f; }
            for (int i = 0; i < 4; ++i) for (int j = 0; j < 4; ++j) { acc[i][j] += a[i] * b[j]; if (MODE != 0) acc2[i][j] += a[i] * c[j]; }
        }
        __syncthreads();
    }
    for (int i = 0; i < 4; ++i) for (int j = 0; j < 4; ++j) {
        const int row = row0 + ty * 4 + i, oc = oc0 + tx * 4 + j;
        if (MODE == 0) ((float*)outp)[(size_t)row * 1024 + oc] = acc[i][j];
        if (MODE == 1) ((bf16*)outp)[(size_t)row * DFF + oc] = f2bf(silu(acc[i][j]) * acc2[i][j]);
        if (MODE == 2) { float v = acc[i][j]; if (b1 >= 0) v *= acc2[i][j]; if (act) v = gelu_tanh(v); ((bf16*)outp)[(size_t)row * NP + oc] = f2bf(v); }
    }
}

__global__ void k_lru_conv(const bf16* P, const float* cw, const float* cb, float* XCB) {
    const int idx = blockIdx.x * blockDim.x + threadIdx.x; const int row = idx >> 9, ch = idx & 511;
    int t, len, base;
    if (row < ML) { t = row % SEQ; len = SEQ; base = row - t; } else { t = (row - ML) % CTXL; len = CTXL; base = row - t; }
    float v = cb[ch];
    for (int k = 0; k < 4; ++k) { const int tt = t + k - 2; if (tt >= 0 && tt < len) v += cw[k * 512 + ch] * bf2f(P[(size_t)(base + tt) * NP + ch]); }
    XCB[idx] = v;
}
__global__ __launch_bounds__(64) void k_lru_scan(const float* XCB, const float* wr, const float* wi, const float* br, const float* bi, const float* SP, float* Y) {
    __shared__ float Wr[64][64], Wi[64][64], xs[64];
    const int h = blockIdx.x, d = blockIdx.y, b = blockIdx.z, j = threadIdx.x, ch = h * 64 + j;
    const float* wrp = wr + ((size_t)d * 8 + h) * 4096; const float* wip = wi + ((size_t)d * 8 + h) * 4096;
    for (int i = 0; i < 64; ++i) { Wr[i][j] = wrp[i * 64 + j]; Wi[i][j] = wip[i * 64 + j]; }
    const float brj = br[d * 512 + ch], bij = bi[d * 512 + ch], sp = SP[d * 512 + ch];
    float hst = 0.f;
    float* Yd = Y + (size_t)d * MT * 512;
    const int total = CTXL + SEQ;
    for (int s = 0; s < total; ++s) {
        int row;
        if (s < CTXL) { const int t = d ? (CTXL - 1 - s) : s; row = ML + b * CTXL + t; }
        else { const int t = d ? (SEQ - 1 - (s - CTXL)) : (s - CTXL); row = b * SEQ + t; }
        const float x = XCB[(size_t)row * 512 + ch];
        __syncthreads();
        xs[j] = x;
        __syncthreads();
        float r = brj, ig = bij;
        for (int i = 0; i < 64; ++i) { const float xv = xs[i]; r += xv * Wr[i][j]; ig += xv * Wi[i][j]; }
        r = sigmoidf(r); ig = sigmoidf(ig);
        const float la = -r * sp, a = expf(la), bx = sqrtf(-expm1f(2.f * la)) * (ig * x);
        hst = a * hst + bx;
        Yd[(size_t)row * 512 + ch] = hst;
    }
}
__global__ void k_mix_combine(const bf16* P, const float* Y, const float* scw, const float* scb, const bf16* CMW, const float* cmb, bf16* MIX) {
    const int idx = blockIdx.x * blockDim.x + threadIdx.x; const int row = idx >> 10, c = idx & 1023;
    int t, len, base; bool lat = row < ML;
    if (lat) { t = row % SEQ; len = SEQ; base = row - t; } else { t = (row - ML) % CTXL; len = CTXL; base = row - t; }
    const bf16* Pr = P + (size_t)row * NP;
    float o;
    if (c < 512) { o = bf2f(Pr[512 + c]) * (Y[(size_t)row * 512 + c] + Y[(size_t)MT * 512 + (size_t)row * 512 + c]); }
    else if (c < 768) { const int cc = c - 512; float v = scb[cc];
        for (int k = 0; k < 3; ++k) { const int tt = t + k - 1; bool ok = tt >= 0 && tt < len; if (lat) ok = ok && ((tt >> 6) == (t >> 6));
            if (ok) v += scw[k * 256 + cc] * bf2f(P[(size_t)(base + tt) * NP + 1280 + cc]); }
        o = bf2f(Pr[1024 + cc]) * v; }
    else { const int cc = c - 768, h = cc >> 6, p = t & 127, cb0 = base + (t - p); float s = cmb[h * 128 + p];
        for (int q = 0; q < 128; ++q) s += bf2f(CMW[(h * 128 + p) * 128 + q]) * bf2f(P[(size_t)(cb0 + q) * NP + 1792 + cc]);
        o = bf2f(Pr[1536 + cc]) * s; }
    MIX[(size_t)row * D + c] = f2bf(o);
}

extern "C" void kernel_launch(void* const* d_in, const int* in_sizes, int n_in, void* d_out, int out_size, void* d_ws, size_t ws_size, hipStream_t stream) {
    if (n_in != 23 || ws_size < WS_END || out_size != ML * D) { fprintf(stderr, "kernel_launch: unexpected shapes (n_in %d ws %zu out %d)\n", n_in, ws_size, out_size); return; }
    const float* x = (const float*)d_in[0]; const float* c = (const float*)d_in[1]; const float* ctx = (const float*)d_in[2]; const float* cctx = (const float*)d_in[3];
    const float* w_mod = (const float*)d_in[4]; const float* b_mod = (const float*)d_in[5]; const float* norm_pre = (const float*)d_in[6]; const float* norm_post = (const float*)d_in[7];
    const float* ffn_w_in = (const float*)d_in[8]; const float* ffn_w_out = (const float*)d_in[9]; const float* w_mix_in = (const float*)d_in[10]; const float* w_mix_out = (const float*)d_in[11];
    const float* lru_conv_w = (const float*)d_in[12]; const float* lru_conv_b = (const float*)d_in[13]; const float* lru_w_r = (const float*)d_in[14]; const float* lru_b_r = (const float*)d_in[15];
    const float* lru_w_i = (const float*)d_in[16]; const float* lru_b_i = (const float*)d_in[17]; const float* lru_lambda = (const float*)d_in[18];
    const float* sc_conv_w = (const float*)d_in[19]; const float* sc_conv_b = (const float*)d_in[20]; const float* cm_w_s = (const float*)d_in[21]; const float* cm_b_s = (const float*)d_in[22];
    unsigned char* ws = (unsigned char*)d_ws;
    float* MOD = (float*)(ws + WS_MOD); bf16* GW = (bf16*)(ws + WS_GW); bf16* CMW = (bf16*)(ws + WS_CMW); float* SP = (float*)(ws + WS_SP);
    float* XC = (float*)(ws + WS_XC); bf16* WMO = (bf16*)(ws + WS_WMO); bf16* WMI = (bf16*)(ws + WS_WMI); bf16* W2 = (bf16*)(ws + WS_W2); bf16* W1 = (bf16*)(ws + WS_W1);
    bf16* HA = (bf16*)(ws + WS_HA); bf16* MIX = (bf16*)(ws + WS_MIX); bf16* ACT = (bf16*)(ws + WS_ACT); bf16* P = (bf16*)(ws + WS_P); float* Yf = (float*)(ws + WS_P);
    float* out = (float*)d_out;

    for (int l = 0; l < 2; ++l) for (int f = 0; f < 2; ++f) {
        k_transpose<<<dim3(5632 / 32, 1024 / 32), dim3(32, 8), 0, stream>>>(ffn_w_in + ((size_t)l * 2 + f) * 1024 * 5632, W1 + ((size_t)l * 2 + f) * 5632 * 1024, 1024, 5632, 1);
        k_transpose<<<dim3(1024 / 32, 2816 / 32), dim3(32, 8), 0, stream>>>(ffn_w_out + ((size_t)l * 2 + f) * 2816 * 1024, W2 + ((size_t)l * 2 + f) * 1024 * 2816, 2816, 1024, 0);
    }
    for (int l = 0; l < 2; ++l) {
        k_transpose<<<dim3(2304 / 32, 1024 / 32), dim3(32, 8), 0, stream>>>(w_mix_in + (size_t)l * 1024 * 2304, WMI + (size_t)l * 2304 * 1024, 1024, 2304, 2);
        k_transpose<<<dim3(1024 / 32, 1024 / 32), dim3(32, 8), 0, stream>>>(w_mix_out + (size_t)l * 1024 * 1024, WMO + (size_t)l * 1024 * 1024, 1024, 1024, 0);
    }
    k_prep_small<<<(2 * 2 * 2 * 8 * 64 * 64 + 255) / 256, 256, 0, stream>>>(lru_w_r, lru_w_i, cm_w_s, lru_lambda, GW, CMW, SP);
    k_mod<<<dim3(9216 / 256, 2), 256, 0, stream>>>(c, cctx, w_mod, b_mod, MOD);
    k_norm_mod<<<MT / 4, 256, 0, stream>>>(x, ctx, norm_pre, MOD, 0, HA);

    for (int l = 0; l < DEPTH; ++l) {
        const bool last = (l == DEPTH - 1);
        const float* modl = MOD + (size_t)l * 9 * 9216; const float* modn = MOD + (size_t)(l + 1) * 9 * 9216;
        const float* gpre = norm_pre + (size_t)l * 3 * D; const float* gpost = norm_post + (size_t)l * 3 * D;
        k_gemm<1><<<dim3(DFF / 64, MT / 64), 256, 0, stream>>>(HA, W1 + ((size_t)l * 2 + 0) * 5632 * 1024, 1024, ACT, 0);
        k_gemm<0><<<dim3(D / 64, MT / 64), 256, 0, stream>>>(ACT, W2 + ((size_t)l * 2 + 0) * 1024 * 2816, 2816, Yf, 0);
        k_resid<<<MT / 4, 256, 0, stream>>>(Yf, l == 0 ? x : out, l == 0 ? ctx : XC, out, XC, gpost + 0 * D, modl, 0, 0.5f, gpre + 1 * D, modl, 1, HA, 0);
        k_gemm<2><<<dim3(NP / 64, MT / 64), 256, 0, stream>>>(HA, WMI + (size_t)l * 2304 * 1024, 1024, P, 0);
        float* XCB2 = (float*)(ws + WS_HA); float* Y2 = (float*)(ws + WS_ACT);
        k_lru_conv<<<MT * 512 / 256, 256, 0, stream>>>(P, lru_conv_w + (size_t)l * 4 * 512, lru_conv_b + (size_t)l * 512, XCB2);
        k_lru_scan<<<dim3(8, 2, 8), 64, 0, stream>>>(XCB2, lru_w_r + (size_t)l * 2 * 8 * 4096, lru_w_i + (size_t)l * 2 * 8 * 4096, lru_b_r + (size_t)l * 1024, lru_b_i + (size_t)l * 1024, SP + (size_t)l * 1024, Y2);
        k_mix_combine<<<MT * 1024 / 256, 256, 0, stream>>>(P, Y2, sc_conv_w + (size_t)l * 3 * 256, sc_conv_b + (size_t)l * 256, CMW + (size_t)l * 4 * 128 * 128, cm_b_s + (size_t)l * 4 * 128, MIX);
        const int rows1 = last ? ML : MT;
        k_gemm<0><<<dim3(D / 64, rows1 / 64), 256, 0, stream>>>(MIX, WMO + (size_t)l * 1024 * 1024, 1024, Yf, 0);
        k_resid<<<rows1 / 4, 256, 0, stream>>>(Yf, out, XC, out, XC, gpost + 1 * D, modl, 1, 1.0f, gpre + 2 * D, modl, 2, HA, 0);
        k_gemm<1><<<dim3(DFF / 64, rows1 / 64), 256, 0, stream>>>(HA, W1 + ((size_t)l * 2 + 1) * 5632 * 1024, 1024, ACT, 0);
        k_gemm<0><<<dim3(D / 64, rows1 / 64), 256, 0, stream>>>(ACT, W2 + ((size_t)l * 2 + 1) * 1024 * 2816, 2816, Yf, 0);
        k_resid<<<rows1 / 4, 256, 0, stream>>>(Yf, out, XC, out, XC, gpost + 2 * D, modl, 2, 0.5f, last ? nullptr : norm_pre + (size_t)(l + 1) * 3 * D, modn, 0, last ? nullptr : HA, 0);
    }
}
```
